# Optimizing an MI355X kernel written in HIP

```python
import math
import jax, jax.numpy as jnp
from jax import lax
import numpy as np

D_MODEL = 2048
BATCH = 4
SEQ = 2048
DEPTH = 1

DIFF_V_DIM = 128
DIFF_QK_DIM = 64
DIFF_WIDTH = D_MODEL // 2
DIFF_HEADS = DIFF_WIDTH // DIFF_V_DIM
FOX_HEAD_DIM = 128
FOX_WIDTH = D_MODEL // 2
FOX_HEADS = FOX_WIDTH // FOX_HEAD_DIM
ROPE_THETA = 500000.0
ROPE_DIM = DIFF_QK_DIM // 4
BLOCK_Q = 128
EPS = 1e-6

SPLIT_SIZES = (
    DIFF_HEADS * 2 * DIFF_QK_DIM,
    DIFF_HEADS * 2 * DIFF_QK_DIM,
    DIFF_WIDTH,
    DIFF_WIDTH,
    FOX_WIDTH,
    FOX_WIDTH,
    FOX_WIDTH,
    FOX_WIDTH,
    FOX_HEADS,
    D_MODEL,
    D_MODEL,
)
N_IN = sum(SPLIT_SIZES)

kernel_name = "hybrid_diffattn_fox_gated_block"


def rmsnorm(x, g):
    xf = x.astype(jnp.float32)
    y = xf * lax.rsqrt(jnp.mean(xf * xf, axis=-1, keepdims=True) + EPS)
    return (y * g.astype(jnp.float32)).astype(x.dtype)


def partial_rope(x, pos):
    half = ROPE_DIM // 2
    inv = ROPE_THETA ** (-jnp.arange(half, dtype=jnp.float32) * 2.0 / ROPE_DIM)
    ang = pos.astype(jnp.float32)[:, None] * inv[None, :]
    shape = (1, pos.shape[0]) + (1,) * (x.ndim - 3) + (half,)
    cos = jnp.cos(ang).reshape(shape).astype(x.dtype)
    sin = jnp.sin(ang).reshape(shape).astype(x.dtype)
    x1 = x[..., :half]
    x2 = x[..., half:ROPE_DIM]
    return jnp.concatenate([x1 * cos - x2 * sin, x2 * cos + x1 * sin, x[..., ROPE_DIM:]], axis=-1)


def causal_mask(q0, kend):
    qpos = jnp.arange(q0, q0 + BLOCK_Q)
    kpos = jnp.arange(kend)
    return qpos[:, None] >= kpos[None, :]


def diff_attention(q, k, v, lam):
    S = q.shape[1]
    scale = DIFF_QK_DIM ** -0.5
    outs = []
    for i in range(S // BLOCK_Q):
        q0, q1 = i * BLOCK_Q, (i + 1) * BLOCK_Q
        s = jnp.einsum('bqhmd,bkhmd->bhmqk', q[:, q0:q1], k[:, :q1]).astype(jnp.float32) * scale
        s = jnp.where(causal_mask(q0, q1), s, -jnp.inf)
        p = jax.nn.softmax(s, axis=-1)
        a = p[:, :, 0] - lam * p[:, :, 1]
        outs.append(jnp.einsum('bhqk,bkhd->bqhd', a.astype(v.dtype), v[:, :q1]))
    return jnp.concatenate(outs, axis=1)


def forgetting_attention(q, k, v, log_f):
    S = q.shape[1]
    scale = FOX_HEAD_DIM ** -0.5
    c = jnp.cumsum(log_f, axis=1).transpose(0, 2, 1)
    outs = []
    for i in range(S // BLOCK_Q):
        q0, q1 = i * BLOCK_Q, (i + 1) * BLOCK_Q
        s = jnp.einsum('bqhd,bkhd->bhqk', q[:, q0:q1], k[:, :q1]).astype(jnp.float32) * scale
        s = s + (c[:, :, q0:q1, None] - c[:, :, None, :q1])
        s = jnp.where(causal_mask(q0, q1), s, -jnp.inf)
        p = jax.nn.softmax(s, axis=-1)
        outs.append(jnp.einsum('bhqk,bkhd->bqhd', p.astype(v.dtype), v[:, :q1]))
    return jnp.concatenate(outs, axis=1)


def hybrid_mixer(h, w_in, lq1, lk1, lq2, lk2, g_subln, b_f, w_proj_a, w_proj_b, w_out, layer_idx):
    B, S, _ = h.shape
    pos = jnp.arange(S)
    z = jnp.einsum('bsd,dn->bsn', h, w_in)
    idx = np.cumsum(np.array(SPLIT_SIZES))[:-1].tolist()
    qa, ka, va, ga, qb, kb, vb, gb, fl, ma, mb = jnp.split(z, idx, axis=-1)

    qa = partial_rope(qa.reshape(B, S, DIFF_HEADS, 2, DIFF_QK_DIM), pos)
    ka = partial_rope(ka.reshape(B, S, DIFF_HEADS, 2, DIFF_QK_DIM), pos)
    va = va.reshape(B, S, DIFF_HEADS, DIFF_V_DIM)
    lam_init = 0.8 - 0.6 * math.exp(-0.3 * layer_idx)
    lam = (jnp.exp(jnp.sum(lq1.astype(jnp.float32) * lk1.astype(jnp.float32)))
           - jnp.exp(jnp.sum(lq2.astype(jnp.float32) * lk2.astype(jnp.float32))) + lam_init)
    oa = diff_attention(qa, ka, va, lam)
    oa = rmsnorm(oa, g_subln) * (1.0 - lam_init)
    oa = oa.reshape(B, S, DIFF_WIDTH) * jax.nn.silu(ga)
    ya = jnp.einsum('bsw,wd->bsd', oa, w_proj_a)

    log_f = jax.nn.log_sigmoid((fl + b_f).astype(jnp.float32))
    ob = forgetting_attention(qb.reshape(B, S, FOX_HEADS, FOX_HEAD_DIM),
                              kb.reshape(B, S, FOX_HEADS, FOX_HEAD_DIM),
                              vb.reshape(B, S, FOX_HEADS, FOX_HEAD_DIM), log_f)
    ob = ob.reshape(B, S, FOX_WIDTH) * jax.nn.silu(gb)
    yb = jnp.einsum('bsw,wd->bsd', ob, w_proj_b)

    m = jax.nn.sigmoid(ma) * ya + jax.nn.sigmoid(mb) * yb
    return jnp.einsum('bsd,de->bse', m, w_out)


def setup_inputs(seed: int = 0) -> dict:
    key = jax.random.key(seed)
    ks = jax.random.split(key, 14)
    f32 = jnp.float32
    x = jax.random.normal(ks[0], (BATCH, SEQ, D_MODEL), f32)
    g_norm = 1.0 + 0.02 * jax.random.normal(ks[1], (DEPTH, D_MODEL), f32)
    w_in = jax.random.normal(ks[2], (DEPTH, D_MODEL, N_IN), f32) * D_MODEL ** -0.5
    lambda_q1 = 0.1 * jax.random.normal(ks[3], (DEPTH, DIFF_QK_DIM), f32)
    lambda_k1 = 0.1 * jax.random.normal(ks[4], (DEPTH, DIFF_QK_DIM), f32)
    lambda_q2 = 0.1 * jax.random.normal(ks[5], (DEPTH, DIFF_QK_DIM), f32)
    lambda_k2 = 0.1 * jax.random.normal(ks[6], (DEPTH, DIFF_QK_DIM), f32)
    g_subln = 1.0 + 0.02 * jax.random.normal(ks[7], (DEPTH, DIFF_V_DIM), f32)
    b_forget = jax.random.uniform(ks[8], (DEPTH, FOX_HEADS), f32, minval=1.0, maxval=4.0)
    w_proj_a = jax.random.normal(ks[9], (DEPTH, DIFF_WIDTH, D_MODEL), f32) * DIFF_WIDTH ** -0.5
    w_proj_b = jax.random.normal(ks[10], (DEPTH, FOX_WIDTH, D_MODEL), f32) * FOX_WIDTH ** -0.5
    w_out = jax.random.normal(ks[11], (DEPTH, D_MODEL, D_MODEL), f32) * D_MODEL ** -0.5
    g_final = 1.0 + 0.02 * jax.random.normal(ks[12], (D_MODEL,), f32)
    return {"x": x, "g_norm": g_norm, "w_in": w_in,
            "lambda_q1": lambda_q1, "lambda_k1": lambda_k1,
            "lambda_q2": lambda_q2, "lambda_k2": lambda_k2,
            "g_subln": g_subln, "b_forget": b_forget,
            "w_proj_a": w_proj_a, "w_proj_b": w_proj_b, "w_out": w_out,
            "g_final": g_final}


def reference(x, g_norm, w_in, lambda_q1, lambda_k1, lambda_q2, lambda_k2, g_subln,
              b_forget, w_proj_a, w_proj_b, w_out, g_final):
    for l in range(DEPTH):
        h = rmsnorm(x, g_norm[l])
        x = x + hybrid_mixer(h, w_in[l], lambda_q1[l], lambda_k1[l], lambda_q2[l], lambda_k2[l],
                             g_subln[l], b_forget[l], w_proj_a[l], w_proj_b[l], w_out[l], l)
    return rmsnorm(x, g_final)
```

```cpp
#include <hip/hip_runtime.h>
#include <hip/hip_cooperative_groups.h>
#include <cstdio>
#include <cstdint>
namespace cg = cooperative_groups;

#define LAS __attribute__((address_space(3)))
typedef unsigned short bf16_t;
typedef short bf16x8 __attribute__((ext_vector_type(8)));
typedef float f32x4 __attribute__((ext_vector_type(4)));
typedef float f32x16 __attribute__((ext_vector_type(16)));
typedef unsigned u32x4 __attribute__((ext_vector_type(4)));
typedef unsigned u32x2 __attribute__((ext_vector_type(2)));

constexpr int DM = 2048, NBATCH = 4, SEQ = 2048, MT = NBATCH * SEQ, NIN = 12296;
constexpr int ZW = 10240;
constexpr int Z_QA = 0, Z_KA = 1024, Z_QB = 2048, Z_KB = 3072, Z_GA = 4096, Z_GB = 5120, Z_MA = 6144, Z_MB = 8192;
constexpr float EPSN = 1e-6f;
constexpr float LOG2E = 1.4426950408889634f;
constexpr size_t MiB = 1u << 20;
constexpr size_t WS_CTL = 0;
constexpr size_t WS_WTIN = 2 * MiB;
constexpr size_t WS_WTPA = 50 * MiB, WS_WTPB = 54 * MiB;
constexpr size_t WS_WTOUT = 58 * MiB;
constexpr size_t WS_H = 66 * MiB;
constexpr size_t WS_Z1 = 98 * MiB;
constexpr size_t WS_VT = 258 * MiB;
constexpr size_t WS_OAG = 290 * MiB, WS_OBG = 306 * MiB;
constexpr size_t WS_M = 322 * MiB;
constexpr size_t WS_LOGF = 354 * MiB;
constexpr size_t WS_CUM = WS_LOGF + 256 * 1024;
constexpr size_t WS_ROPE = WS_CUM + 256 * 1024;
constexpr size_t WS_ROWSQ = 355 * MiB;
constexpr size_t WS_END = 356 * MiB;
constexpr int LDS_BYTES = 132096;

__device__ __forceinline__ unsigned pkbf(float lo, float hi) {
    typedef float f2_t __attribute__((ext_vector_type(2))); typedef __bf16 b2_t __attribute__((ext_vector_type(2)));
    f2_t v = {lo, hi}; b2_t r = __builtin_convertvector(v, b2_t); return __builtin_bit_cast(unsigned, r);
}
__device__ __forceinline__ float bflo(unsigned w) { return __uint_as_float(w << 16); }
__device__ __forceinline__ float bfhi(unsigned w) { return __uint_as_float(w & 0xffff0000u); }
__device__ __forceinline__ float fexp2(float x) { return __builtin_amdgcn_exp2f(x); }
__device__ __forceinline__ float frcp(float x) { return __builtin_amdgcn_rcpf(x); }
__device__ __forceinline__ float sigmoidf_(float x) { return frcp(1.0f + fexp2(-x * LOG2E)); }
__device__ __forceinline__ int opaque_tid() { int t = threadIdx.x; asm volatile("" : "+v"(t)); return t; }
__device__ __forceinline__ float wave_sum(float v) {
#pragma unroll
    for (int o = 1; o < 64; o <<= 1) v += __shfl_xor(v, o);
    return v;
}

namespace pg8 {
constexpr int BM = 256, BK = 64, HALF = 128, HTB = HALF * BK * 2, STAGE_BYTES = 8 * HTB, NXCD = 8, WGM = 8;
__host__ __device__ __forceinline__ int lds_byte(int r, int c) { const int st = (r >> 4) * 2 + (c >> 5), rr = r & 15, cc = c & 31, ob = rr * 64 + cc * 2; return st * 1024 + (ob ^ (((ob >> 9) & 1) << 5)); }
__host__ __device__ __forceinline__ void stage_rc(int b, int& R, int& C) { const int st = b / 1024, sb = b % 1024, swz = sb ^ (((sb >> 9) & 1) << 5); R = (st >> 1) * 16 + swz / 64; C = (st & 1) * 32 + (swz % 64) / 2; }
__host__ __device__ __forceinline__ int perm32(int rho) { const int n = rho >> 4, i = rho & 15; return 8 * (i >> 2) + 4 * n + (i & 3); }

struct Unit { int pm, pn, kind; const char* A; const char* B; };

__device__ __forceinline__ void tile_map(int nM, int nN, int wgid, int& pm, int& pn) {
    const int nwg = nM * nN;
    { const int q = nwg / NXCD, r = nwg % NXCD, xcd = wgid % NXCD, off = wgid / NXCD; wgid = (xcd < r ? xcd * (q + 1) : r * (q + 1) + (xcd - r) * q) + off; }
    const int nig = WGM * nN, gid = wgid / nig, fm = gid * WGM, gsz = (nM - fm) < WGM ? (nM - fm) : WGM;
    pm = fm + ((wgid % nig) % gsz); pn = (wgid % nig) / gsz;
}

template <class Epi, class Sched, bool ALIGN_EPI, bool SP2>
__device__ __forceinline__ void gemm_phase(LAS unsigned char* lds, const int K, const Sched& S, const Epi& E) {
    const int tid = opaque_tid(), wid = __builtin_amdgcn_readfirstlane(tid >> 6), lane = tid & 63, wr = wid >> 2, wc = wid & 3, fr = lane & 15, fq = lane >> 4;
    const int nt = K / BK;
    unsigned voffA[2], voffB[2];
#pragma unroll
    for (int i = 0; i < 2; ++i) { int R, C; stage_rc(tid * 16 + i * 8192, R, C); const int Rb = Epi::PERM ? ((R & ~31) + perm32(R & 31)) : R;
        voffA[i] = (unsigned)(R * K + C) * 2u; voffB[i] = (unsigned)(Rb * K + C) * 2u; }
    const size_t kstep = (size_t)(BK * 2);
    const size_t hstep = (size_t)HALF * K * 2;
    const unsigned ldsw = (unsigned)wid * 1024u;
    const int aoff = lds_byte(wr * 64 + fr, fq * 8), boff = lds_byte(wc * 32 + fr, fq * 8);
#define PG8_SA(b, h) (((b) * 2 + (h)) * HTB)
#define PG8_SB(b, h) ((4 + (b) * 2 + (h)) * HTB)
#define PG8_STAGE(bufoff, gbase, voff) do { _Pragma("unroll") for (int _i = 0; _i < 2; ++_i) \
        __builtin_amdgcn_global_load_lds((const unsigned*)((const char*)(gbase) + (voff)[_i]), (LAS unsigned*)(lds + (bufoff) + ldsw + _i * 8192), 16, 0, 0); } while (0)
#define PG8_LDA(dst, b, h) do { _Pragma("unroll") for (int m = 0; m < 4; ++m) _Pragma("unroll") for (int k = 0; k < 2; ++k) dst[m][k] = *(const LAS bf16x8*)(lds + PG8_SA(b, h) + aoff + m * 2048 + k * 1024); } while (0)
#define PG8_LDB(dst, b, h) do { _Pragma("unroll") for (int n = 0; n < 2; ++n) _Pragma("unroll") for (int k = 0; k < 2; ++k) dst[n][k] = *(const LAS bf16x8*)(lds + PG8_SB(b, h) + boff + n * 2048 + k * 1024); } while (0)
#define PG8_MMA(ai, bj, At, Bt) do { __builtin_amdgcn_s_setprio(1); _Pragma("unroll") for (int m = 0; m < 4; ++m) _Pragma("unroll") for (int n = 0; n < 2; ++n) _Pragma("unroll") for (int k = 0; k < 2; ++k) \
        acc[ai][bj][m][n] = __builtin_amdgcn_mfma_f32_16x16x32_bf16(Bt[n][k], At[m][k], acc[ai][bj][m][n], 0, 0, 0); __builtin_amdgcn_s_setprio(0); } while (0)
#define PG8_WAIT_V(n) asm volatile("s_waitcnt vmcnt(" #n ")" ::: "memory")
#define PG8_WAIT_L(n) asm volatile("s_waitcnt lgkmcnt(" #n ")" ::: "memory")
#define PG8_BAR __builtin_amdgcn_s_barrier()
#define PG8_SCHED __builtin_amdgcn_sched_barrier(0)
    Unit cur, nxt; int ui = 0;
    if (!S.next(0, cur)) return;
    f32x4 acc[2][2][4][2];
#pragma unroll
    for (int a = 0; a < 2; ++a)
#pragma unroll
        for (int b = 0; b < 2; ++b)
#pragma unroll
            for (int m = 0; m < 4; ++m)
#pragma unroll
                for (int n = 0; n < 2; ++n) acc[a][b][m][n] = (f32x4){0.f, 0.f, 0.f, 0.f};
    bf16x8 At[4][2], B0[2][2], B1[2][2];
    const char* cA = cur.A; const char* cB = cur.B;
    if constexpr (SP2) {
        PG8_STAGE(PG8_SB(0, 0), cB, voffB); PG8_STAGE(PG8_SB(0, 1), cB + hstep, voffB); PG8_STAGE(PG8_SA(0, 0), cA, voffA); PG8_STAGE(PG8_SA(0, 1), cA + hstep, voffA);
        if (wr == 1) PG8_BAR;
        PG8_WAIT_V(2); PG8_BAR;
        PG8_STAGE(PG8_SB(1, 0), cB + kstep, voffB); PG8_STAGE(PG8_SA(1, 0), cA + kstep, voffA); PG8_STAGE(PG8_SB(1, 1), cB + hstep + kstep, voffB);
        PG8_WAIT_V(6); PG8_BAR;
    } else {
        PG8_STAGE(PG8_SB(0, 0), cB, voffB); PG8_STAGE(PG8_SA(0, 0), cA, voffA); PG8_STAGE(PG8_SB(0, 1), cB + hstep, voffB); PG8_STAGE(PG8_SA(0, 1), cA + hstep, voffA);
        if (wr == 1) PG8_BAR;
        PG8_WAIT_V(4); PG8_BAR;
        PG8_STAGE(PG8_SB(1, 0), cB + kstep, voffB); PG8_STAGE(PG8_SA(1, 0), cA + kstep, voffA); PG8_STAGE(PG8_SB(1, 1), cB + hstep + kstep, voffB);
        PG8_WAIT_V(6); PG8_BAR;
    }
    for (;;) {
        const bool has_next = S.next(ui + 1, nxt);
        const char* nA = has_next ? nxt.A : cA; const char* nB = has_next ? nxt.B : cB;
        for (int t = 0; t < nt; t += 2) {
            const bool last = (t == nt - 2);
            const char* a1 = cA + (size_t)(t + 1) * kstep;
            const char* a2 = last ? nA : cA + (size_t)(t + 2) * kstep; const char* b2 = last ? nB : cB + (size_t)(t + 2) * kstep;
            const char* a3 = a2 + kstep; const char* b3 = b2 + kstep;
            if constexpr (SP2) {
            PG8_LDB(B0, 0, 0); PG8_LDB(B1, 0, 1); PG8_SCHED; PG8_LDA(At, 0, 0); PG8_STAGE(PG8_SA(1, 1), a1 + hstep, voffA);
            PG8_WAIT_V(8); PG8_WAIT_L(0); PG8_BAR; PG8_MMA(0, 0, At, B0); PG8_MMA(0, 1, At, B1); PG8_BAR; PG8_SCHED;
            PG8_LDA(At, 0, 1); PG8_STAGE(PG8_SB(0, 0), b2, voffB); PG8_STAGE(PG8_SB(0, 1), b2 + hstep, voffB); PG8_STAGE(PG8_SA(0, 0), a2, voffA);
            PG8_WAIT_V(8); PG8_WAIT_L(0); PG8_BAR; PG8_MMA(1, 0, At, B0); PG8_MMA(1, 1, At, B1); PG8_BAR; PG8_SCHED;
            PG8_LDB(B0, 1, 0); PG8_LDB(B1, 1, 1); PG8_SCHED; PG8_LDA(At, 1, 0); PG8_STAGE(PG8_SA(0, 1), a2 + hstep, voffA);
            PG8_WAIT_V(8); PG8_WAIT_L(0); PG8_BAR; PG8_MMA(0, 0, At, B0); PG8_MMA(0, 1, At, B1); PG8_BAR; PG8_SCHED;
            PG8_LDA(At, 1, 1); PG8_STAGE(PG8_SB(1, 0), b3, voffB); PG8_STAGE(PG8_SB(1, 1), b3 + hstep, voffB); PG8_STAGE(PG8_SA(1, 0), a3, voffA);
            PG8_WAIT_V(8); PG8_WAIT_L(0); PG8_BAR; PG8_MMA(1, 0, At, B0); PG8_MMA(1, 1, At, B1); PG8_BAR; PG8_SCHED;
            } else {
            PG8_LDB(B0, 0, 0); PG8_SCHED; PG8_LDA(At, 0, 0); PG8_STAGE(PG8_SA(1, 1), a1 + hstep, voffA);
            PG8_WAIT_L(8); PG8_BAR; PG8_WAIT_L(0); PG8_MMA(0, 0, At, B0); PG8_BAR; PG8_SCHED;
            PG8_LDB(B1, 0, 1); PG8_STAGE(PG8_SB(0, 0), b2, voffB);
            PG8_BAR; PG8_WAIT_L(0); PG8_MMA(0, 1, At, B1); PG8_BAR;
            PG8_LDA(At, 0, 1); PG8_STAGE(PG8_SA(0, 0), a2, voffA);
            PG8_BAR; PG8_WAIT_L(0); PG8_MMA(1, 0, At, B0); PG8_BAR; PG8_SCHED;
            PG8_STAGE(PG8_SB(0, 1), b2 + hstep, voffB);
            PG8_WAIT_V(6); PG8_BAR; PG8_MMA(1, 1, At, B1); PG8_BAR;
            PG8_LDB(B0, 1, 0); PG8_SCHED; PG8_LDA(At, 1, 0); PG8_STAGE(PG8_SA(0, 1), a2 + hstep, voffA);
            PG8_WAIT_L(8); PG8_BAR; PG8_WAIT_L(0); PG8_MMA(0, 0, At, B0); PG8_BAR; PG8_SCHED;
            PG8_LDB(B1, 1, 1); PG8_STAGE(PG8_SB(1, 0), b3, voffB);
            PG8_BAR; PG8_WAIT_L(0); PG8_MMA(0, 1, At, B1); PG8_BAR;
            PG8_LDA(At, 1, 1); PG8_STAGE(PG8_SA(1, 0), a3, voffA);
            PG8_BAR; PG8_WAIT_L(0); PG8_MMA(1, 0, At, B0); PG8_BAR; PG8_SCHED;
            PG8_STAGE(PG8_SB(1, 1), b3 + hstep, voffB);
            PG8_WAIT_V(6); PG8_BAR; PG8_MMA(1, 1, At, B1); PG8_BAR;
            }
        }
        if constexpr (ALIGN_EPI) { if (wr == 0) PG8_BAR; }
        const bool keep = E(acc, cur, wr, wc, fr, fq);
        if (!has_next) break;
        if (!keep) {
#pragma unroll
        for (int a = 0; a < 2; ++a)
#pragma unroll
            for (int b = 0; b < 2; ++b)
#pragma unroll
                for (int m = 0; m < 4; ++m)
#pragma unroll
                    for (int n = 0; n < 2; ++n) acc[a][b][m][n] = (f32x4){0.f, 0.f, 0.f, 0.f};
        }
        cur = nxt; cA = nA; cB = nB; ++ui;
        if constexpr (ALIGN_EPI) { if (wr == 1) PG8_BAR; }
    }
    PG8_WAIT_V(0);
    if constexpr (!ALIGN_EPI) { if (wr == 0) PG8_BAR; }
    PG8_BAR;
#undef PG8_SA
#undef PG8_SB
#undef PG8_STAGE
#undef PG8_LDA
#undef PG8_LDB
#undef PG8_MMA
#undef PG8_WAIT_V
#undef PG8_WAIT_L
#undef PG8_BAR
#undef PG8_SCHED
}

struct Epi1 {
    static constexpr bool PERM = true;
    bf16_t* z1; bf16_t* vt; const float* rope;
    __device__ __forceinline__ bool operator()(f32x4 (&acc)[2][2][4][2], const Unit& u, int wr, int wc, int fr, int fq) const {
        const int row0 = u.pm * BM + wr * 64 + fr, col0 = u.pn * BM + wc * 32 + 8 * fq;
        if (u.kind == 1) {
#pragma unroll
            for (int ai = 0; ai < 2; ++ai)
#pragma unroll
                for (int m = 0; m < 4; ++m) { bf16_t* rowp = vt + (size_t)(row0 + ai * HALF + m * 16) * MT + col0;
#pragma unroll
                    for (int bj = 0; bj < 2; ++bj) { const f32x4 v0 = acc[ai][bj][m][0], v1 = acc[ai][bj][m][1]; u32x4 w;
                        w.x = pkbf(v0[0], v0[1]); w.y = pkbf(v0[2], v0[3]); w.z = pkbf(v1[0], v1[1]); w.w = pkbf(v1[2], v1[3]); *(u32x4*)(rowp + bj * HALF) = w; } }
            return false;
        }
        const bool dorope = (u.pn < 8) && ((wc & 1) == 0);
#pragma unroll
        for (int ai = 0; ai < 2; ++ai)
#pragma unroll
            for (int m = 0; m < 4; ++m) { const int row = row0 + ai * HALF + m * 16; bf16_t* rowp = z1 + (size_t)row * ZW + col0;
                f32x4 c0 = {1.f, 1.f, 1.f, 1.f}, c1 = c0, s0 = {0.f, 0.f, 0.f, 0.f}, s1 = s0;
                if (dorope) { const f32x4* rp = (const f32x4*)(rope + (size_t)(row & (SEQ - 1)) * 16); c0 = rp[0]; c1 = rp[1]; s0 = rp[2]; s1 = rp[3];
                    if (fq == 0) { s0 = -s0; s1 = -s1; } if (fq >= 2) { c0 = (f32x4){1.f, 1.f, 1.f, 1.f}; c1 = c0; s0 = (f32x4){0.f, 0.f, 0.f, 0.f}; s1 = s0; } }
#pragma unroll
                for (int bj = 0; bj < 2; ++bj) { f32x4 v0 = acc[ai][bj][m][0], v1 = acc[ai][bj][m][1];
                    if (dorope) { f32x4 p0, p1;
#pragma unroll
                        for (int e = 0; e < 4; ++e) { p0[e] = __shfl_xor(v0[e], 16); p1[e] = __shfl_xor(v1[e], 16); }
                        v0 = v0 * c0 + p0 * s0; v1 = v1 * c1 + p1 * s1; }
                    u32x4 w; w.x = pkbf(v0[0], v0[1]); w.y = pkbf(v0[2], v0[3]); w.z = pkbf(v1[0], v1[1]); w.w = pkbf(v1[2], v1[3]); *(u32x4*)(rowp + bj * HALF) = w; } }
        return false;
    }
};
struct Epi2 {
    static constexpr bool PERM = true;
    const bf16_t* z1; bf16_t* mo;
    __device__ __forceinline__ bool operator()(f32x4 (&acc)[2][2][4][2], const Unit& u, int wr, int wc, int fr, int fq) const {
        const int row0 = u.pm * BM + wr * 64 + fr, col0 = u.pn * BM + wc * 32 + 8 * fq;
#pragma unroll
        for (int ai = 0; ai < 2; ++ai)
#pragma unroll
            for (int m = 0; m < 4; ++m) { const int row = row0 + ai * HALF + m * 16; const bf16_t* zr = z1 + (size_t)row * ZW + col0;
#pragma unroll
                for (int bj = 0; bj < 2; ++bj) {
                    const u32x4 wb = *(const u32x4*)(zr + Z_MB + bj * HALF);
                    float eb[8];
#pragma unroll
                    for (int e = 0; e < 4; ++e) { eb[2 * e] = 1.0f + fexp2(-bflo(wb[e]) * LOG2E); eb[2 * e + 1] = 1.0f + fexp2(-bfhi(wb[e]) * LOG2E); }
                    if (u.kind == 0) {
                        const u32x4 wa = *(const u32x4*)(zr + Z_MA + bj * HALF);
#pragma unroll
                        for (int e = 0; e < 4; ++e) { const float ea0 = 1.0f + fexp2(-bflo(wa[e]) * LOG2E), ea1 = 1.0f + fexp2(-bfhi(wa[e]) * LOG2E);
                            const float r0 = eb[2 * e] * frcp(ea0), r1 = eb[2 * e + 1] * frcp(ea1);
                            if (e < 2) { acc[ai][bj][m][0][2 * e] *= r0; acc[ai][bj][m][0][2 * e + 1] *= r1; } else { acc[ai][bj][m][1][2 * e - 4] *= r0; acc[ai][bj][m][1][2 * e - 3] *= r1; } }
                    } else {
                        const f32x4 v0 = acc[ai][bj][m][0], v1 = acc[ai][bj][m][1]; u32x4 w;
                        w.x = pkbf(v0[0] * frcp(eb[0]), v0[1] * frcp(eb[1])); w.y = pkbf(v0[2] * frcp(eb[2]), v0[3] * frcp(eb[3]));
                        w.z = pkbf(v1[0] * frcp(eb[4]), v1[1] * frcp(eb[5])); w.w = pkbf(v1[2] * frcp(eb[6]), v1[3] * frcp(eb[7]));
                        *(u32x4*)(mo + (size_t)row * DM + col0 + bj * HALF) = w;
                    }
                } }
        return u.kind == 0;
    }
};
struct Epi3 {
    static constexpr bool PERM = false;
    const float* x; float* out; float* rowsq;
    __device__ __forceinline__ bool operator()(f32x4 (&acc)[2][2][4][2], const Unit& u, int wr, int wc, int fr, int fq) const {
        const int row0 = u.pm * BM + wr * 64 + fr, col0 = u.pn * BM + wc * 32 + 4 * fq;
#pragma unroll
        for (int ai = 0; ai < 2; ++ai)
#pragma unroll
            for (int m = 0; m < 4; ++m) { const int row = row0 + ai * HALF + m * 16; const size_t off = (size_t)row * DM + col0; float ss = 0.f;
#pragma unroll
                for (int bj = 0; bj < 2; ++bj)
#pragma unroll
                    for (int n = 0; n < 2; ++n) { const f32x4 xv = *(const f32x4*)(x + off + bj * HALF + n * 16); const f32x4 v = xv + acc[ai][bj][m][n];
                        *(f32x4*)(out + off + bj * HALF + n * 16) = v; ss += (v[0] * v[0] + v[1] * v[1]) + (v[2] * v[2] + v[3] * v[3]); }
                ss += __shfl_xor(ss, 16); ss += __shfl_xor(ss, 32);
                if (fq == 0) rowsq[(size_t)row * 32 + u.pn * 4 + wc] = ss; }
        return false;
    }
};

constexpr size_t TS2K = (size_t)256 * 2048 * 2, TS1K = (size_t)256 * 1024 * 2;
struct Sched1 {
    const char* H; const char* WT; int G, c;
    __device__ __forceinline__ bool next(int i, Unit& u) const {
        const int L = i * G + c; if (L >= 1536) return false;
        int pm, pn;
        if (L < 1280) { tile_map(32, 40, L, pm, pn); u.kind = 0; u.A = H + (size_t)pm * TS2K; u.B = WT + (size_t)pn * TS2K; }
        else { tile_map(8, 32, L - 1280, pm, pn); u.kind = 1; u.A = WT + (size_t)(40 + pm) * TS2K; u.B = H + (size_t)pn * TS2K; }
        u.pm = pm; u.pn = pn; return true;
    }
};
struct Sched2 {
    const char *OA, *OB, *WA, *WB; int G, c;
    __device__ __forceinline__ bool next(int i, Unit& u) const {
        const int L = (i >> 1) * G + c; if (L >= 256) return false;
        int pm, pn; tile_map(32, 8, L, pm, pn); u.pm = pm; u.pn = pn; u.kind = i & 1;
        u.A = ((i & 1) ? OB : OA) + (size_t)pm * TS1K; u.B = ((i & 1) ? WB : WA) + (size_t)pn * TS1K; return true;
    }
};
struct Sched3 {
    const char *A, *B; int G, c;
    __device__ __forceinline__ bool next(int i, Unit& u) const {
        const int L = i * G + c; if (L >= 256) return false;
        int pm, pn; tile_map(32, 8, L, pm, pn); u.pm = pm; u.pn = pn; u.kind = 0; u.A = A + (size_t)pm * TS2K; u.B = B + (size_t)pn * TS2K; return true;
    }
};
}

struct Params {
    const float *x, *g_norm, *w_in, *lq1, *lk1, *lq2, *lk2, *g_subln, *b_f, *wpa, *wpb, *wout, *g_final;
    float* out; unsigned char* ws;
    unsigned char order[24];
    int pad[2];
};

__device__ __forceinline__ void transpose_item(const float* W, int ldw, int k0, int n0src, bf16_t* WT, int K, int row0dst, LAS float* scr, int lane) {
#pragma unroll 8
    for (int i = 0; i < 32; ++i) { const int kk = 2 * i + (lane >> 5); scr[kk * 33 + (lane & 31)] = W[(size_t)(k0 + kk) * ldw + n0src + (lane & 31)]; }
    asm volatile("s_waitcnt lgkmcnt(0)" ::: "memory");
    const int c = lane & 7;
#pragma unroll
    for (int j = 0; j < 4; ++j) { const int n = (lane >> 3) + 8 * j; const LAS float* s = scr + (8 * c) * 33 + n;
        u32x4 o; o.x = pkbf(s[0 * 33], s[1 * 33]); o.y = pkbf(s[2 * 33], s[3 * 33]); o.z = pkbf(s[4 * 33], s[5 * 33]); o.w = pkbf(s[6 * 33], s[7 * 33]);
        *(u32x4*)(WT + (size_t)(row0dst + n) * K + k0 + 8 * c) = o; }
    asm volatile("s_waitcnt lgkmcnt(0)" ::: "memory");
}
__device__ __forceinline__ int win_src_col(int d0) {
    if (d0 < 2048) return d0;
    if (d0 < 3072) return 4096 + (d0 - 2048);
    if (d0 < 4096) return 5120 + (d0 - 3072);
    if (d0 < 5120) return 3072 + (d0 - 4096);
    if (d0 < 6144) return 7168 + (d0 - 5120);
    if (d0 < 8192) return 8200 + (d0 - 6144);
    if (d0 < 10240) return 10248 + (d0 - 8192);
    if (d0 < 11264) return 2048 + (d0 - 10240);
    return 6144 + (d0 - 11264);
}
__device__ __forceinline__ void prep_phase(const Params& p, LAS unsigned char* lds) {
    const int tid = opaque_tid(), lane = tid & 63, wave = __builtin_amdgcn_readfirstlane(tid >> 6);
    const int G = gridDim.x, gw = blockIdx.x * 8 + wave, NGW = G * 8;
    unsigned char* ws = p.ws;
    if (blockIdx.x == 0 && tid == 0) *(unsigned*)(ws + WS_CTL) = 0u;
    for (int e = blockIdx.x * 512 + tid; e < SEQ * 8; e += G * 512) {
        const int pos = e >> 3, i = e & 7;
        const float inv = exp2f(-(float)i * 0.125f * 18.931568569324174f);
        const float ang = (float)pos * inv;
        const double rev = (double)ang * 0.15915494309189535; const float fr = (float)(rev - __builtin_rint(rev));
        float* rp = (float*)(ws + WS_ROPE) + (size_t)pos * 16;
        rp[i] = __builtin_amdgcn_cosf(fr); rp[8 + i] = __builtin_amdgcn_sinf(fr);
    }
    LAS float* wfl = (LAS float*)lds;
#pragma unroll
    for (int i = 0; i < 4; ++i) { const int k = 4 * tid + i; const f32x4 a = *(const f32x4*)(p.w_in + (size_t)k * NIN + 8192), b = *(const f32x4*)(p.w_in + (size_t)k * NIN + 8196);
        wfl[0 * 2048 + k] = a[0]; wfl[1 * 2048 + k] = a[1]; wfl[2 * 2048 + k] = a[2]; wfl[3 * 2048 + k] = a[3];
        wfl[4 * 2048 + k] = b[0]; wfl[5 * 2048 + k] = b[1]; wfl[6 * 2048 + k] = b[2]; wfl[7 * 2048 + k] = b[3]; }
    __syncthreads();
    bf16_t* H = (bf16_t*)(ws + WS_H); float* logf_ = (float*)(ws + WS_LOGF);
    for (int row = gw; row < MT; row += NGW) {
        const f32x4* xr = (const f32x4*)(p.x + (size_t)row * DM) + lane; const f32x4* gr = (const f32x4*)p.g_norm + lane;
        f32x4 v[8]; float ss = 0.f;
#pragma unroll
        for (int j = 0; j < 8; ++j) { v[j] = xr[64 * j]; ss += (v[j][0] * v[j][0] + v[j][1] * v[j][1]) + (v[j][2] * v[j][2] + v[j][3] * v[j][3]); }
        const float rn = 1.0f / sqrtf(wave_sum(ss) * (1.0f / DM) + EPSN);
        u32x2* ho = (u32x2*)(H + (size_t)row * DM) + lane;
#pragma unroll
        for (int j = 0; j < 8; ++j) { v[j] = v[j] * rn * gr[64 * j]; u32x2 w; w.x = pkbf(v[j][0], v[j][1]); w.y = pkbf(v[j][2], v[j][3]); ho[64 * j] = w; }
        float mine = 0.f;
#pragma unroll 1
        for (int jj = 0; jj < 8; ++jj) { float a = 0.f;
#pragma unroll
            for (int j = 0; j < 8; ++j) { const f32x4 w = *(const LAS f32x4*)(wfl + jj * 2048 + 256 * j + 4 * lane); a += (v[j][0] * w[0] + v[j][1] * w[1]) + (v[j][2] * w[2] + v[j][3] * w[3]); }
            a = wave_sum(a); mine = (lane == jj) ? a : mine; }
        if (lane < 8) { const float xv = mine + p.b_f[lane]; const float ls = fminf(xv, 0.f) - __logf(1.0f + __expf(-fabsf(xv)));
            logf_[(size_t)((row >> 11) * 8 + lane) * SEQ + (row & (SEQ - 1))] = ls; }
    }
    __syncthreads();
    LAS float* scr = (LAS float*)(lds + wave * 16384);
    bf16_t* WTIN = (bf16_t*)(ws + WS_WTIN);
    for (int it = gw; it < 16384; it += NGW) {
        const float* W; int ldw, k0, n0, K, r0; bf16_t* WT;
        if (it < 12288) { const int kb = it / 384, ng = it % 384; W = p.w_in; ldw = NIN; k0 = 64 * kb; n0 = win_src_col(32 * ng); WT = WTIN; K = 2048; r0 = 32 * ng; }
        else if (it < 13312) { const int r = it - 12288; W = p.wpa; ldw = 2048; k0 = 64 * (r >> 6); n0 = 32 * (r & 63); WT = (bf16_t*)(ws + WS_WTPA); K = 1024; r0 = n0; }
        else if (it < 14336) { const int r = it - 13312; W = p.wpb; ldw = 2048; k0 = 64 * (r >> 6); n0 = 32 * (r & 63); WT = (bf16_t*)(ws + WS_WTPB); K = 1024; r0 = n0; }
        else { const int r = it - 14336; W = p.wout; ldw = 2048; k0 = 64 * (r >> 6); n0 = 32 * (r & 63); WT = (bf16_t*)(ws + WS_WTOUT); K = 2048; r0 = n0; }
        transpose_item(W, ldw, k0, n0, WT, K, r0, scr, lane);
    }
}
__device__ __forceinline__ void cumsum_task(const Params& p) {
    const int tid = opaque_tid(), lane = tid & 63;
    if (tid >= 64) return;
    for (int s = blockIdx.x; s < 32; s += gridDim.x) {
        const f32x4* src = (const f32x4*)((const float*)(p.ws + WS_LOGF) + (size_t)s * SEQ + 32 * lane);
        f32x4 v[8]; float run = 0.f;
#pragma unroll
        for (int j = 0; j < 8; ++j) { v[j] = src[j];
#pragma unroll
            for (int e = 0; e < 4; ++e) { run += v[j][e]; v[j][e] = run; } }
        float inc = run;
#pragma unroll
        for (int o = 1; o < 64; o <<= 1) { const float t = __shfl_up(inc, o); if (lane >= o) inc += t; }
        const float base = inc - run;
        f32x4* dst = (f32x4*)((float*)(p.ws + WS_CUM) + (size_t)s * SEQ + 32 * lane);
#pragma unroll
        for (int j = 0; j < 8; ++j) dst[j] = (v[j] + base) * LOG2E;
    }
}

namespace att {
constexpr int KSTR = 272, VSTR = 144, KBUF = 64 * KSTR, VBUF = 128 * VSTR;
constexpr int OFF_K = 0, OFF_V = 2 * KBUF, OFF_C = OFF_V + 2 * VBUF, OFF_Q = OFF_C + 8192;
#define ATT_MFMA(a, b, c) __builtin_amdgcn_mfma_f32_32x32x16_bf16((a), (b), (c), 0, 0, 0)

template <bool FOX>
__device__ __forceinline__ void unit(LAS unsigned char* lds, const Params& p, const int b, const int h, const int qb, const float lam) {
    const int tid = opaque_tid(), wid = __builtin_amdgcn_readfirstlane(tid >> 6), lane = tid & 63, l32 = lane & 31, hi = lane >> 5;
    constexpr int R = FOX ? 256 : 128, NKS = FOX ? 8 : 4;
    const float sl2 = (FOX ? 0.08838834764831845f : 0.125f) * LOG2E;
    const int q0 = qb * R, qw0 = q0 + 32 * (FOX ? wid : (wid & 3)), map = FOX ? 0 : (wid >> 2);
    const int nt = (q0 + R) / 64;
    const size_t tok0 = (size_t)b * SEQ;
    const bf16_t* z1 = (const bf16_t*)(p.ws + WS_Z1);
    const bf16_t* Kg = z1 + tok0 * ZW + (FOX ? Z_KB : Z_KA) + h * 128;
    const bf16_t* Vg = (const bf16_t*)(p.ws + WS_VT) + (size_t)((FOX ? 1024 : 0) + h * 128) * MT + tok0;
    const bf16_t* Qg = z1 + (tok0 + qw0 + l32) * ZW + (FOX ? Z_QB : Z_QA) + h * 128 + map * 64 + hi * 8;
    __syncthreads();
    bf16x8 qf[NKS];
#pragma unroll
    for (int ks = 0; ks < NKS; ++ks) qf[ks] = *(const bf16x8*)(Qg + ks * 16);
    if (FOX) { const f32x4 cv = *(const f32x4*)((const float*)(p.ws + WS_CUM) + (size_t)(b * 8 + h) * SEQ + 4 * tid); *(LAS f32x4*)(lds + OFF_C + 16 * tid) = cv; }
    unsigned kgo[2], vgo[2]; int klo[2], vlo[2];
#pragma unroll
    for (int i = 0; i < 2; ++i) { const int c = tid + 512 * i; kgo[i] = (unsigned)((c >> 4) * ZW + (c & 15) * 8); klo[i] = (c >> 4) * KSTR + (c & 15) * 16;
        vgo[i] = (unsigned)((c >> 3) * MT + (c & 7) * 8); vlo[i] = (c >> 3) * VSTR + (c & 7) * 16; }
    u32x4 kr[2], vr[2];
#pragma unroll
    for (int i = 0; i < 2; ++i) { kr[i] = *(const u32x4*)(Kg + kgo[i]); vr[i] = *(const u32x4*)(Vg + vgo[i]); }
#pragma unroll
    for (int i = 0; i < 2; ++i) { *(LAS u32x4*)(lds + OFF_K + klo[i]) = kr[i]; *(LAS u32x4*)(lds + OFF_V + vlo[i]) = vr[i]; }
    __syncthreads();
    const int pi = (l32 & 0x13) | ((l32 & 4) << 1) | ((l32 & 8) >> 1);
    const int koff = pi * KSTR + map * 128 + hi * 16, voff = l32 * VSTR + hi * 16;
    const int qrow = qw0 + l32;
    float cq2 = 0.f; if (FOX) cq2 = *(const LAS float*)(lds + OFF_C + 4 * qrow);
    f32x16 O[4];
#pragma unroll
    for (int d = 0; d < 4; ++d)
#pragma unroll
        for (int r = 0; r < 16; ++r) O[d][r] = 0.f;
    float mrun = -INFINITY, lrun = 0.f;
    for (int t = 0; t < nt; ++t) {
        const int cur = t & 1; const bool more = (t + 1 < nt);
        if (more) {
#pragma unroll
            for (int i = 0; i < 2; ++i) { kr[i] = *(const u32x4*)(Kg + (size_t)(t + 1) * 64 * ZW + kgo[i]); vr[i] = *(const u32x4*)(Vg + (t + 1) * 64 + vgo[i]); }
        }
        if (64 * t <= qw0 + 31) {
            const LAS unsigned char* kb = lds + OFF_K + cur * KBUF + koff;
            f32x16 s0, s1;
#pragma unroll
            for (int r = 0; r < 16; ++r) { s0[r] = 0.f; s1[r] = 0.f; }
#pragma unroll
            for (int ks = 0; ks < NKS; ++ks) { const bf16x8 a0 = *(const LAS bf16x8*)(kb + ks * 32), a1 = *(const LAS bf16x8*)(kb + 32 * KSTR + ks * 32);
                s0 = ATT_MFMA(a0, qf[ks], s0); s1 = ATT_MFMA(a1, qf[ks], s1); }
            const int kbase = 64 * t + 8 * hi;
            if (FOX) {
                const LAS float* cp = (const LAS float*)(lds + OFF_C) + kbase;
#pragma unroll
                for (int g = 0; g < 2; ++g)
#pragma unroll
                    for (int q4 = 0; q4 < 2; ++q4) { const f32x4 c0 = *(const LAS f32x4*)(cp + 16 * g + 4 * q4), c1 = *(const LAS f32x4*)(cp + 32 + 16 * g + 4 * q4);
#pragma unroll
                        for (int e = 0; e < 4; ++e) { const int r = 8 * g + 4 * q4 + e; s0[r] = s0[r] * sl2 + (cq2 - c0[e]); s1[r] = s1[r] * sl2 + (cq2 - c1[e]); } }
            } else {
#pragma unroll
                for (int r = 0; r < 16; ++r) { s0[r] *= sl2; s1[r] *= sl2; }
            }
            if (64 * t + 63 > qw0) {
#pragma unroll
                for (int r = 0; r < 16; ++r) { const int k0 = kbase + 16 * (r >> 3) + (r & 7);
                    s0[r] = (k0 > qrow) ? -INFINITY : s0[r]; s1[r] = (k0 + 32 > qrow) ? -INFINITY : s1[r]; }
            }
            float mx = fmaxf(s0[0], s1[0]);
#pragma unroll
            for (int r = 1; r < 16; ++r) mx = fmaxf(mx, fmaxf(s0[r], s1[r]));
            mx = fmaxf(mx, __shfl_xor(mx, 32));
            const float mn = fmaxf(mrun, mx), alpha = fexp2(mrun - mn); mrun = mn;
            float rs = 0.f;
#pragma unroll
            for (int r = 0; r < 16; ++r) { s0[r] = fexp2(s0[r] - mn); s1[r] = fexp2(s1[r] - mn); rs += s0[r] + s1[r]; }
            lrun = lrun * alpha + rs;
#pragma unroll
            for (int d = 0; d < 4; ++d)
#pragma unroll
                for (int r = 0; r < 16; ++r) O[d][r] *= alpha;
            bf16x8 pb[4];
#pragma unroll
            for (int s = 0; s < 2; ++s) { u32x4 w0, w1;
#pragma unroll
                for (int e = 0; e < 4; ++e) { w0[e] = pkbf(s0[8 * s + 2 * e], s0[8 * s + 2 * e + 1]); w1[e] = pkbf(s1[8 * s + 2 * e], s1[8 * s + 2 * e + 1]); }
                pb[s] = __builtin_bit_cast(bf16x8, w0); pb[2 + s] = __builtin_bit_cast(bf16x8, w1); }
            const LAS unsigned char* vb = lds + OFF_V + cur * VBUF + voff;
#pragma unroll
            for (int d = 0; d < 4; ++d)
#pragma unroll
                for (int k4 = 0; k4 < 4; ++k4) { const bf16x8 a = *(const LAS bf16x8*)(vb + 32 * d * VSTR + k4 * 32); O[d] = ATT_MFMA(a, pb[k4], O[d]); }
        }
        if (more) {
#pragma unroll
            for (int i = 0; i < 2; ++i) { *(LAS u32x4*)(lds + OFF_K + (cur ^ 1) * KBUF + klo[i]) = kr[i]; *(LAS u32x4*)(lds + OFF_V + (cur ^ 1) * VBUF + vlo[i]) = vr[i]; }
        }
        __syncthreads();
    }
    const float linv = frcp(lrun + __shfl_xor(lrun, 32));
    const size_t tok = tok0 + qrow;
    if (FOX) {
        const bf16_t* gp = z1 + tok * ZW + Z_GB + h * 128 + 4 * hi; bf16_t* op = (bf16_t*)(p.ws + WS_OBG) + tok * 1024 + h * 128 + 4 * hi;
#pragma unroll
        for (int d = 0; d < 4; ++d)
#pragma unroll
            for (int g = 0; g < 4; ++g) { const u32x2 gw = *(const u32x2*)(gp + 32 * d + 8 * g); const float g0 = bflo(gw.x), g1 = bfhi(gw.x), g2 = bflo(gw.y), g3 = bfhi(gw.y);
                u32x2 w; w.x = pkbf(O[d][4 * g] * linv * g0 * sigmoidf_(g0), O[d][4 * g + 1] * linv * g1 * sigmoidf_(g1));
                w.y = pkbf(O[d][4 * g + 2] * linv * g2 * sigmoidf_(g2), O[d][4 * g + 3] * linv * g3 * sigmoidf_(g3)); *(u32x2*)(op + 32 * d + 8 * g) = w; }
    } else {
        LAS f32x4* xp = (LAS f32x4*)(lds) + (size_t)(wid & 3) * 16 * 64 + lane;
        if (wid >= 4) { const float f = lam * linv;
#pragma unroll
            for (int d = 0; d < 4; ++d)
#pragma unroll
                for (int g = 0; g < 4; ++g) xp[(4 * d + g) * 64] = (f32x4){O[d][4 * g] * f, O[d][4 * g + 1] * f, O[d][4 * g + 2] * f, O[d][4 * g + 3] * f}; }
        __syncthreads();
        if (wid < 4) { float ss = 0.f;
#pragma unroll
            for (int d = 0; d < 4; ++d)
#pragma unroll
                for (int g = 0; g < 4; ++g) { const f32x4 xv = xp[(4 * d + g) * 64];
#pragma unroll
                    for (int e = 0; e < 4; ++e) { const float v = O[d][4 * g + e] * linv - xv[e]; O[d][4 * g + e] = v; ss += v * v; } }
            ss += __shfl_xor(ss, 32);
            const float rn = 0.8f / sqrtf(ss * (1.0f / 128.0f) + EPSN);
            const bf16_t* gp = z1 + tok * ZW + Z_GA + h * 128 + 4 * hi; bf16_t* op = (bf16_t*)(p.ws + WS_OAG) + tok * 1024 + h * 128 + 4 * hi; const float* sg = p.g_subln + 4 * hi;
#pragma unroll
            for (int d = 0; d < 4; ++d)
#pragma unroll
                for (int g = 0; g < 4; ++g) { const u32x2 gw = *(const u32x2*)(gp + 32 * d + 8 * g); const f32x4 sv = *(const f32x4*)(sg + 32 * d + 8 * g);
                    const float g0 = bflo(gw.x), g1 = bfhi(gw.x), g2 = bflo(gw.y), g3 = bfhi(gw.y);
                    u32x2 w; w.x = pkbf(O[d][4 * g] * rn * sv[0] * g0 * sigmoidf_(g0), O[d][4 * g + 1] * rn * sv[1] * g1 * sigmoidf_(g1));
                    w.y = pkbf(O[d][4 * g + 2] * rn * sv[2] * g2 * sigmoidf_(g2), O[d][4 * g + 3] * rn * sv[3] * g3 * sigmoidf_(g3)); *(u32x2*)(op + 32 * d + 8 * g) = w; } }
    }
}

__device__ __forceinline__ void phase(LAS unsigned char* lds, const Params& p) {
    const int tid = opaque_tid(), lane = tid & 63;
    const float lam = __expf(wave_sum(p.lq1[lane] * p.lk1[lane])) - __expf(wave_sum(p.lq2[lane] * p.lk2[lane])) + 0.2f;
    unsigned* ctr = (unsigned*)(p.ws + WS_CTL);
    volatile LAS unsigned* qw = (volatile LAS unsigned*)(lds + OFF_Q);
    for (;;) {
        __syncthreads();
        if (tid == 0) *qw = atomicAdd(ctr, 1u);
        __syncthreads();
        const unsigned u = __builtin_amdgcn_readfirstlane(*qw);
        if (u >= 768u) break;
        const int cls = p.order[u >> 5], bh = u & 31, b = bh >> 3, h = bh & 7;
        if (cls < 8) unit<true>(lds, p, b, h, cls, lam); else unit<false>(lds, p, b, h, cls - 8, lam);
    }
}
}

__device__ __forceinline__ void final_phase(const Params& p) {
    const int tid = opaque_tid(), lane = tid & 63, wave = tid >> 6; const int gw = blockIdx.x * 8 + wave, NGW = gridDim.x * 8;
    const float* rowsq = (const float*)(p.ws + WS_ROWSQ);
    for (int row = gw; row < MT; row += NGW) {
        const float ss = wave_sum(lane < 32 ? rowsq[(size_t)row * 32 + lane] : 0.f);
        const float rn = 1.0f / sqrtf(ss * (1.0f / DM) + EPSN);
        f32x4* o = (f32x4*)(p.out + (size_t)row * DM) + lane; const f32x4* g = (const f32x4*)p.g_final + lane;
#pragma unroll
        for (int j = 0; j < 8; ++j) { const f32x4 v = o[64 * j]; o[64 * j] = v * rn * g[64 * j]; }
    }
}

__global__ void __launch_bounds__(512, 2) hybrid_block_fwd(Params p) {
    extern __shared__ __attribute__((aligned(16))) unsigned char lds_raw[];
    LAS unsigned char* lds = (LAS unsigned char*)lds_raw;
    cg::grid_group grid = cg::this_grid();
    unsigned char* ws = p.ws; const int G = gridDim.x, c = blockIdx.x;

    prep_phase(p, lds);
    grid.sync();

    cumsum_task(p);
    { pg8::Sched1 S{(const char*)(ws + WS_H), (const char*)(ws + WS_WTIN), G, c};
      pg8::Epi1 E{(bf16_t*)(ws + WS_Z1), (bf16_t*)(ws + WS_VT), (const float*)(ws + WS_ROPE)};
      pg8::gemm_phase<pg8::Epi1, pg8::Sched1, true, true>(lds, 2048, S, E); }
    grid.sync();

    att::phase(lds, p);
    grid.sync();

    { pg8::Sched2 S{(const char*)(ws + WS_OAG), (const char*)(ws + WS_OBG), (const char*)(ws + WS_WTPA), (const char*)(ws + WS_WTPB), G, c};
      pg8::Epi2 E{(const bf16_t*)(ws + WS_Z1), (bf16_t*)(ws + WS_M)};
      pg8::gemm_phase<pg8::Epi2, pg8::Sched2, true, true>(lds, 1024, S, E); }
    grid.sync();

    { pg8::Sched3 S{(const char*)(ws + WS_M), (const char*)(ws + WS_WTOUT), G, c};
      pg8::Epi3 E{p.x, p.out, (float*)(ws + WS_ROWSQ)};
      pg8::gemm_phase<pg8::Epi3, pg8::Sched3, true, true>(lds, 2048, S, E); }
    grid.sync();

    final_phase(p);
}

extern "C" void kernel_launch(void* const* d_in, const int* in_sizes, int n_in, void* d_out, int out_size, void* d_ws, size_t ws_size, hipStream_t stream) {
    static int grid = 0;
    if (grid == 0) {
        if (n_in != 13 || in_sizes[0] != MT * DM || out_size != MT * DM || ws_size < WS_END) { fprintf(stderr, "kernel_launch: unexpected shapes (n_in %d, in0 %d, out %d, ws %zu); nothing launched\n", n_in, n_in > 0 ? in_sizes[0] : -1, out_size, ws_size); grid = -1; return; }
        int dev = 0, cus = 0, per_cu = 0;
        if (hipGetDevice(&dev) != hipSuccess || hipDeviceGetAttribute(&cus, hipDeviceAttributeMultiprocessorCount, dev) != hipSuccess) { grid = -1; return; }
        if (hipFuncSetAttribute((const void*)hybrid_block_fwd, hipFuncAttributeMaxDynamicSharedMemorySize, LDS_BYTES) != hipSuccess) { fprintf(stderr, "kernel_launch: hipFuncSetAttribute failed\n"); grid = -1; return; }
        if (hipOccupancyMaxActiveBlocksPerMultiprocessor(&per_cu, (const void*)hybrid_block_fwd, 512, LDS_BYTES) != hipSuccess || per_cu < 1) { fprintf(stderr, "kernel_launch: occupancy query gave %d\n", per_cu); per_cu = 1; }
        (void)hipGetLastError();
        grid = cus * (per_cu > 1 ? 1 : per_cu);
    }
    if (grid < 0) return;
    Params p{};
    p.x = (const float*)d_in[0]; p.g_norm = (const float*)d_in[1]; p.w_in = (const float*)d_in[2];
    p.lq1 = (const float*)d_in[3]; p.lk1 = (const float*)d_in[4]; p.lq2 = (const float*)d_in[5]; p.lk2 = (const float*)d_in[6];
    p.g_subln = (const float*)d_in[7]; p.b_f = (const float*)d_in[8]; p.wpa = (const float*)d_in[9]; p.wpb = (const float*)d_in[10];
    p.wout = (const float*)d_in[11]; p.g_final = (const float*)d_in[12]; p.out = (float*)d_out; p.ws = (unsigned char*)d_ws;
    static const unsigned char order[24] = {7, 6, 5, 23, 22, 21, 4, 20, 19, 18, 3, 17, 16, 2, 15, 14, 13, 1, 12, 11, 10, 0, 9, 8};
    for (int i = 0; i < 24; ++i) p.order[i] = order[i];
    void* args[] = {&p};
    const hipError_t e = hipLaunchCooperativeKernel((const void*)hybrid_block_fwd, dim3(grid), dim3(512), args, LDS_BYTES, stream);
    if (e != hipSuccess) fprintf(stderr, "kernel_launch: cooperative launch failed: %s (grid %d)\n", hipGetErrorString(e), grid);
}
```
